# Optimizing an MI355X kernel written in HIP

```python
import math
import jax, jax.numpy as jnp
from jax import lax
import numpy as np

D_MODEL = 1024
BATCH = 8
SEQ = 4096
DEPTH = 1

CHUNK = 64
D_MIX = D_MODEL
SSD_HEADS = 8
SSD_HEAD_DIM = 64
SSD_GROUPS = 2
SSD_STATE = 128
SSD_CONV = 4
D_SSD = SSD_HEADS * SSD_HEAD_DIM
D_XBC = D_SSD + 2 * SSD_GROUPS * SSD_STATE
FOX_HEADS = 8
FOX_HEAD_DIM = 64
D_FOX = FOX_HEADS * FOX_HEAD_DIM
Q_BLOCK = 128
PROJ_SPLITS = (D_SSD, D_SSD + D_XBC, D_SSD + D_XBC + SSD_HEADS,
               D_SSD + D_XBC + SSD_HEADS + D_FOX,
               D_SSD + D_XBC + SSD_HEADS + 2 * D_FOX,
               D_SSD + D_XBC + SSD_HEADS + 3 * D_FOX)
D_IN_PROJ = D_SSD + D_XBC + SSD_HEADS + 3 * D_FOX + FOX_HEADS
N_EXPERT_GROUPS = 4
EXPERTS_PER_GROUP = 4
TOP_K_IN_GROUP = 2
D_EXPERT = 512
D_PLE = 256
EPS = 1e-6

kernel_name = 'hymba_ssd_fox_hiermoe_ple'


def rms_norm(x, g):
    xf = x.astype(jnp.float32)
    y = xf * lax.rsqrt(jnp.mean(xf * xf, axis=-1, keepdims=True) + EPS)
    return (y * g.astype(jnp.float32)).astype(x.dtype)


def ssd_scan(xs, dt, a, bm, cm):
    b, s, G, R, P = xs.shape
    N = bm.shape[-1]
    nc = s // CHUNK
    xdt = (xs * dt[..., None]).reshape(b, nc, CHUNK, G, R, P)
    adt = (dt * a).reshape(b, nc, CHUNK, G, R).transpose(0, 3, 4, 1, 2)
    a_cs = jnp.cumsum(adt, axis=-1)
    bc = bm.reshape(b, nc, CHUNK, G, N).astype(xdt.dtype)
    cc = cm.reshape(b, nc, CHUNK, G, N).astype(xdt.dtype)
    causal = jnp.tril(jnp.ones((CHUNK, CHUNK), dtype=bool))
    seg = a_cs[..., :, None] - a_cs[..., None, :]
    decay_in = jnp.exp(jnp.where(causal, seg, -jnp.inf))
    cb = jnp.einsum('bclgn,bcsgn->bgcls', cc, bc)
    y_diag = jnp.einsum('bgcls,bgrcls,bcsgrp->bclgrp', cb, decay_in, xdt)
    decay_st = jnp.exp(a_cs[..., -1:] - a_cs)
    states = jnp.einsum('bclgn,bgrcl,bclgrp->cbgrpn', bc, decay_st, xdt)
    chunk_decay = jnp.exp(a_cs[..., -1]).transpose(3, 0, 1, 2)

    def step(carry, inp):
        st, dec = inp
        return carry * dec[..., None, None] + st, carry

    init = jnp.zeros((b, G, R, P, N), dtype=states.dtype)
    _, prev = lax.scan(step, init, (states, chunk_decay))
    y_off = jnp.einsum('bclgn,cbgrpn,bgrcl->bclgrp', cc, prev, jnp.exp(a_cs))
    return (y_diag + y_off).reshape(b, s, G, R, P)


def ssd_mixer(z, xbc, dt_raw, conv_w, conv_b, dt_bias, a_log, d_skip, g_norm):
    b, s, _ = xbc.shape
    R = SSD_HEADS // SSD_GROUPS
    xbc = lax.conv_general_dilated(xbc, conv_w, window_strides=(1,),
                                   padding=[(SSD_CONV - 1, 0)],
                                   dimension_numbers=('NWC', 'WIO', 'NWC'),
                                   feature_group_count=D_XBC) + conv_b
    xbc = jax.nn.silu(xbc)
    xs, bm, cm = jnp.split(xbc, [D_SSD, D_SSD + SSD_GROUPS * SSD_STATE], axis=-1)
    xs = xs.reshape(b, s, SSD_GROUPS, R, SSD_HEAD_DIM)
    bm = bm.reshape(b, s, SSD_GROUPS, SSD_STATE)
    cm = cm.reshape(b, s, SSD_GROUPS, SSD_STATE)
    dt = jax.nn.softplus(dt_raw.astype(jnp.float32) + dt_bias.astype(jnp.float32))
    dt = dt.reshape(b, s, SSD_GROUPS, R)
    a = -jnp.exp(a_log.astype(jnp.float32)).reshape(SSD_GROUPS, R)
    y = ssd_scan(xs, dt, a, bm, cm)
    y = y + d_skip.reshape(SSD_GROUPS, R)[:, :, None] * xs
    y = y.reshape(b, s, D_SSD)
    return rms_norm(y * jax.nn.silu(z.astype(y.dtype)), g_norm)


def fox_mixer(q, k, v, f_logit, f_bias):
    b, s, _ = q.shape
    q = q.reshape(b, s, FOX_HEADS, FOX_HEAD_DIM).transpose(0, 2, 1, 3)
    k = k.reshape(b, s, FOX_HEADS, FOX_HEAD_DIM).transpose(0, 2, 1, 3)
    v = v.reshape(b, s, FOX_HEADS, FOX_HEAD_DIM).transpose(0, 2, 1, 3)
    log_f = jax.nn.log_sigmoid((f_logit + f_bias).astype(jnp.float32))
    f_cum = jnp.cumsum(log_f, axis=1).transpose(0, 2, 1)
    scale = FOX_HEAD_DIM ** -0.5
    outs = []
    for blk in range(s // Q_BLOCK):
        q0 = blk * Q_BLOCK
        q1 = q0 + Q_BLOCK
        logits = jnp.einsum('bhqd,bhkd->bhqk', q[:, :, q0:q1], k[:, :, :q1]).astype(jnp.float32) * scale
        logits = logits + f_cum[:, :, q0:q1, None] - f_cum[:, :, None, :q1]
        mask = (q0 + jnp.arange(Q_BLOCK))[:, None] >= jnp.arange(q1)[None, :]
        probs = jax.nn.softmax(jnp.where(mask, logits, -jnp.inf), axis=-1)
        outs.append(jnp.einsum('bhqk,bhkd->bhqd', probs.astype(v.dtype), v[:, :, :q1]))
    o = jnp.concatenate(outs, axis=2)
    return o.transpose(0, 2, 1, 3).reshape(b, s, D_FOX)


def hier_moe(h, w_rg, b_rg, w_re, b_re, w_gate, w_up, w_down):
    b, s, _ = h.shape
    grp_prob = jax.nn.softmax((h @ w_rg + b_rg).astype(jnp.float32), axis=-1)
    p_grp, g_idx = lax.top_k(grp_prob, 1)
    grp_onehot = jax.nn.one_hot(g_idx[..., 0], N_EXPERT_GROUPS, dtype=jnp.float32)
    exp_logits = (h @ w_re + b_re).astype(jnp.float32).reshape(b, s, N_EXPERT_GROUPS, EXPERTS_PER_GROUP)
    in_grp = jnp.einsum('bsg,bsge->bse', grp_onehot, exp_logits)
    top_val, top_idx = lax.top_k(in_grp, TOP_K_IN_GROUP)
    w_top = jax.nn.softmax(top_val, axis=-1) * p_grp
    w_exp = jnp.sum(jax.nn.one_hot(top_idx, EXPERTS_PER_GROUP, dtype=jnp.float32) * w_top[..., None], axis=-2)
    combine = (grp_onehot[..., :, None] * w_exp[..., None, :]).astype(h.dtype)
    y = jnp.zeros_like(h)
    for g in range(N_EXPERT_GROUPS):
        act = jax.nn.silu(jnp.einsum('bsd,edf->bsef', h, w_gate[g]))
        hid = act * jnp.einsum('bsd,edf->bsef', h, w_up[g]) * combine[:, :, g, :, None]
        y = y + jnp.einsum('bsef,efd->bsd', hid, w_down[g])
    return y


def setup_inputs(seed: int = 0) -> dict:
    key = jax.random.key(seed)
    ks = jax.random.split(key, 24)
    nrm = jax.random.normal
    L = DEPTH
    x = nrm(ks[0], (BATCH, SEQ, D_MODEL), jnp.float32)
    p = nrm(ks[1], (L, BATCH, SEQ, D_PLE), jnp.float32)
    w_in = nrm(ks[2], (L, D_MODEL, D_IN_PROJ), jnp.float32) * D_MODEL ** -0.5
    conv_w = nrm(ks[3], (L, SSD_CONV, 1, D_XBC), jnp.float32) * SSD_CONV ** -0.5
    conv_b = 0.01 * nrm(ks[4], (L, D_XBC), jnp.float32)
    u = jax.random.uniform(ks[5], (L, SSD_HEADS), jnp.float32)
    dt0 = jnp.exp(u * (math.log(0.1) - math.log(0.001)) + math.log(0.001))
    dt_bias = dt0 + jnp.log(-jnp.expm1(-dt0))
    a_log = jnp.log(jax.random.uniform(ks[6], (L, SSD_HEADS), jnp.float32, 1.0, 16.0))
    d_skip = 1.0 + 0.1 * nrm(ks[7], (L, SSD_HEADS), jnp.float32)
    g_ssd = 1.0 + 0.05 * nrm(ks[8], (L, D_SSD), jnp.float32)
    fox_fbias = 2.0 + 0.5 * nrm(ks[9], (L, FOX_HEADS), jnp.float32)
    w_out = nrm(ks[10], (L, D_MIX, D_MODEL), jnp.float32) * D_MIX ** -0.5
    g_mix = 1.0 + 0.05 * nrm(ks[11], (L, D_MODEL), jnp.float32)
    g_ffn = 1.0 + 0.05 * nrm(ks[12], (L, D_MODEL), jnp.float32)
    w_route_group = nrm(ks[13], (L, D_MODEL, N_EXPERT_GROUPS), jnp.float32) * D_MODEL ** -0.5
    b_route_group = 0.01 * nrm(ks[14], (L, N_EXPERT_GROUPS), jnp.float32)
    w_route_expert = nrm(ks[15], (L, D_MODEL, N_EXPERT_GROUPS * EXPERTS_PER_GROUP), jnp.float32) * D_MODEL ** -0.5
    b_route_expert = 0.01 * nrm(ks[16], (L, N_EXPERT_GROUPS * EXPERTS_PER_GROUP), jnp.float32)
    eshape = (L, N_EXPERT_GROUPS, EXPERTS_PER_GROUP, D_MODEL, D_EXPERT)
    w_exp_gate = nrm(ks[17], eshape, jnp.float32) * D_MODEL ** -0.5
    w_exp_up = nrm(ks[18], eshape, jnp.float32) * D_MODEL ** -0.5
    w_exp_down = nrm(ks[19], (L, N_EXPERT_GROUPS, EXPERTS_PER_GROUP, D_EXPERT, D_MODEL), jnp.float32) * D_EXPERT ** -0.5
    g_ple = 1.0 + 0.05 * nrm(ks[20], (L, D_MODEL), jnp.float32)
    w_ple_proj = nrm(ks[21], (L, D_PLE, D_MODEL), jnp.float32) * D_PLE ** -0.5
    w_ple_gate = nrm(ks[22], (L, D_MODEL, D_MODEL), jnp.float32) * D_MODEL ** -0.5
    g_final = 1.0 + 0.05 * nrm(ks[23], (D_MODEL,), jnp.float32)
    return {'x': x, 'p': p, 'w_in': w_in, 'conv_w': conv_w, 'conv_b': conv_b,
            'dt_bias': dt_bias, 'a_log': a_log, 'd_skip': d_skip, 'g_ssd': g_ssd,
            'fox_fbias': fox_fbias, 'w_out': w_out, 'g_mix': g_mix, 'g_ffn': g_ffn,
            'w_route_group': w_route_group, 'b_route_group': b_route_group,
            'w_route_expert': w_route_expert, 'b_route_expert': b_route_expert,
            'w_exp_gate': w_exp_gate, 'w_exp_up': w_exp_up, 'w_exp_down': w_exp_down,
            'g_ple': g_ple, 'w_ple_proj': w_ple_proj, 'w_ple_gate': w_ple_gate,
            'g_final': g_final}


def reference(x, p, w_in, conv_w, conv_b, dt_bias, a_log, d_skip, g_ssd, fox_fbias,
              w_out, g_mix, g_ffn, w_route_group, b_route_group, w_route_expert,
              b_route_expert, w_exp_gate, w_exp_up, w_exp_down, g_ple, w_ple_proj,
              w_ple_gate, g_final):
    h = x
    for i in range(DEPTH):
        hn = rms_norm(h, g_mix[i])
        proj = hn @ w_in[i]
        z, xbc, dt_raw, q, k, v, f_logit = jnp.split(proj, PROJ_SPLITS, axis=-1)
        y_ssd = ssd_mixer(z, xbc, dt_raw, conv_w[i], conv_b[i], dt_bias[i],
                          a_log[i], d_skip[i], g_ssd[i])
        y_fox = fox_mixer(q, k, v, f_logit, fox_fbias[i])
        mixed = jnp.concatenate([y_ssd.astype(h.dtype), y_fox.astype(h.dtype)], axis=-1)
        h = h + mixed @ w_out[i]
        h = h + hier_moe(rms_norm(h, g_ffn[i]), w_route_group[i], b_route_group[i],
                         w_route_expert[i], b_route_expert[i], w_exp_gate[i],
                         w_exp_up[i], w_exp_down[i])
        gate = jax.nn.sigmoid((rms_norm(h, g_ple[i]) @ w_ple_gate[i]).astype(jnp.float32))
        h = h + ((p[i] @ w_ple_proj[i]).astype(jnp.float32) * gate).astype(h.dtype)
    return rms_norm(h, g_final)
```

```cpp
#include <hip/hip_runtime.h>
#include <cstdio>
#include <cstdint>

#ifndef MK_N_LAUNCHES
#define MK_N_LAUNCHES 0
#endif

#define GAS __attribute__((address_space(1)))
#define LAS __attribute__((address_space(3)))
typedef unsigned short bf16_t;
typedef short bf16x8 __attribute__((ext_vector_type(8)));
typedef short s16x4 __attribute__((ext_vector_type(4)));
typedef float f32x2 __attribute__((ext_vector_type(2)));
typedef float f32x4 __attribute__((ext_vector_type(4)));
typedef float f32x16 __attribute__((ext_vector_type(16)));
typedef unsigned u32x2 __attribute__((ext_vector_type(2)));
typedef unsigned u32x4 __attribute__((ext_vector_type(4)));
typedef __bf16 bf16x2_t __attribute__((ext_vector_type(2)));
#define DI __device__ __forceinline__

constexpr int NB = 8, SEQ = 4096, DM = 1024, MTOK = NB * SEQ;
constexpr int NPROJ = 3072;
constexpr int PC_Z = 0, PC_XBC = 512, PC_Q = 1536, PC_K = 2048, PC_V = 2560;
constexpr int NHEAD = 8, HD = 64, NSTATE = 128, CH = 64, NCHUNK = SEQ / CH;
constexpr int NCLS = 24;
constexpr float EPS = 1e-6f;
constexpr float LOG2E = 1.4426950408889634f;
constexpr float QSCALE = 0.125f * LOG2E;

constexpr size_t MiB = 1u << 20;
constexpr size_t WS_CTL = 0, CTL_ZERO_BYTES = 1 * MiB;
constexpr size_t WS_WIN = 1 * MiB;
constexpr size_t WS_WOUT = 7 * MiB;
constexpr size_t WS_WGU = 9 * MiB;
constexpr size_t WS_WD = 41 * MiB;
constexpr size_t WS_WPP = 57 * MiB;
constexpr size_t WS_WPG = 58 * MiB;
constexpr size_t WS_W16 = 60 * MiB;
constexpr size_t WS_DTF = 61 * MiB;
constexpr size_t WS_FCB = 63 * MiB;
constexpr size_t WS_CD = 64 * MiB;
constexpr size_t WS_WTS = 65 * MiB;
constexpr size_t WS_LIST = 66 * MiB;
constexpr size_t WS_PB = 70 * MiB;
constexpr size_t WS_XN = 86 * MiB;
constexpr size_t WS_PROJ = 150 * MiB;
constexpr size_t WS_HID = WS_PROJ, WS_PP = WS_PROJ + 64 * MiB;
constexpr size_t WS_ST = 342 * MiB;
constexpr size_t WS_MIX = 406 * MiB;
constexpr size_t WS_END = 470 * MiB;
constexpr int CW_CNT = 64;
constexpr int CW_BAR = 4096;

constexpr int RING_BYTES = 131072, AUX_OFF = 131072, AUX_BYTES = 16384, MISC_OFF = AUX_OFF + AUX_BYTES, LDS_BYTES = MISC_OFF + 512;

DI unsigned cvtpk(float lo, float hi) { f32x2 v = {lo, hi}; bf16x2_t b = __builtin_convertvector(v, bf16x2_t); return __builtin_bit_cast(unsigned, b); }
DI bf16_t cvt1(float x) { return (bf16_t)(cvtpk(x, 0.f) & 0xffffu); }
DI float bf2f(unsigned short h) { return __uint_as_float(((unsigned)h) << 16); }
DI float bflo(unsigned w) { return __uint_as_float(w << 16); }
DI float bfhi(unsigned w) { return __uint_as_float(w & 0xffff0000u); }
DI float wave_sum(float v) {
#pragma unroll
    for (int o = 1; o < 64; o <<= 1) v += __shfl_xor(v, o);
    return v;
}
DI float siluf(float x) { return x / (1.f + __expf(-x)); }
DI float sigmoidf_(float x) { return 1.f / (1.f + __expf(-x)); }
DI float softplusf_(float x) { return fmaxf(x, 0.f) + log1pf(__expf(-fabsf(x))); }
#define MFMA32(a, b, c) __builtin_amdgcn_mfma_f32_32x32x16_bf16((a), (b), (c), 0, 0, 0)
DI int crow(int r, int hi) { return (r & 3) + 8 * (r >> 2) + 4 * hi; }
DI bf16x8 pack8(const f32x16& x, int s) {
    u32x4 p; p.x = cvtpk(x[8 * s + 0], x[8 * s + 1]); p.y = cvtpk(x[8 * s + 2], x[8 * s + 3]); p.z = cvtpk(x[8 * s + 4], x[8 * s + 5]); p.w = cvtpk(x[8 * s + 6], x[8 * s + 7]);
    return __builtin_bit_cast(bf16x8, p);
}

namespace pg8 {
constexpr int BM = 256, BK = 64, HALF = 128, HTB = HALF * BK * 2, STAGE_BYTES = 8 * HTB, NXCD = 8, WGM = 8;
__host__ __device__ __forceinline__ int lds_byte(int r, int c) { const int st = (r >> 4) * 2 + (c >> 5), rr = r & 15, cc = c & 31, ob = rr * 64 + cc * 2; return st * 1024 + (ob ^ (((ob >> 9) & 1) << 5)); }
__host__ __device__ __forceinline__ void stage_rc(int b, int& R, int& C) { const int st = b / 1024, sb = b % 1024, swz = sb ^ (((sb >> 9) & 1) << 5); R = (st >> 1) * 16 + swz / 64; C = (st & 1) * 32 + (swz % 64) / 2; }
__host__ __device__ __forceinline__ int perm32(int rho) { const int n = rho >> 4, i = rho & 15; return 8 * (i >> 2) + 4 * n + (i & 3); }

struct Unit {
    int arow0, acnt; const int* alist;
    const bf16_t* b0; const bf16_t* b1;
    int pm, pn, e0, e1;
};
struct Gemm { const bf16_t* A; int lda, ldb, K, ksplit; };
DI int unit_row(const Unit& u, int r) {
    if (u.alist) { int i = u.arow0 + r; i = i < u.acnt ? i : u.acnt - 1; return u.alist[i]; }
    return u.arow0 + r;
}

template <class Epi, class Sched, bool ALIGN_EPI>
__device__ __forceinline__ void gemm_phase(LAS unsigned char* lds, const Gemm g, const Sched& S, const Epi& E) {
    const int tid = threadIdx.x, wid = __builtin_amdgcn_readfirstlane(tid >> 6), lane = tid & 63, wr = wid >> 2, wc = wid & 3, fr = lane & 15, fq = lane >> 4;
    int K_ = g.K, ks_ = g.ksplit; asm volatile("" : "+s"(K_), "+s"(ks_));
    const int K = K_, nt = K / BK, ksplit = ks_;
    unsigned voffB[2];
#pragma unroll
    for (int i = 0; i < 2; ++i) { int R, C; stage_rc(tid * 16 + i * 8192, R, C); const int Rb = Epi::PERM ? ((R & ~31) + perm32(R & 31)) : R; voffB[i] = (unsigned)(Rb * g.ldb + C) * 2u; }
#define PG8_AOFFS(u, o00, o01, o10, o11) do { int t_ = tid; asm volatile("" : "+v"(t_)); int R0, C0, R1, C1; stage_rc(t_ * 16, R0, C0); stage_rc(t_ * 16 + 8192, R1, C1); \
        o00 = (unsigned)(unit_row(u, R0) * g.lda + C0) * 2u; o01 = (unsigned)(unit_row(u, R1) * g.lda + C1) * 2u; \
        o10 = (unsigned)(unit_row(u, HALF + R0) * g.lda + C0) * 2u; o11 = (unsigned)(unit_row(u, HALF + R1) * g.lda + C1) * 2u; } while (0)
    const size_t kstep = (size_t)(BK * 2);
    const size_t hstepB = (size_t)HALF * g.ldb * 2;
    const unsigned ldsw = (unsigned)wid * 1024u;
    const int aoff = lds_byte(wr * 64 + fr, fq * 8), boff = lds_byte(wc * 32 + fr, fq * 8);
    const char* Abase = (const char*)g.A;
#define PG8_SA(b, h) (((b) * 2 + (h)) * HTB)
#define PG8_SB(b, h) ((4 + (b) * 2 + (h)) * HTB)
#define PG8_STAGE(bufoff, gp, v0, v1) do { \
        __builtin_amdgcn_global_load_lds((const unsigned*)((const char*)(gp) + (v0)), (LAS unsigned*)(lds + (bufoff) + ldsw), 16, 0, 0); \
        __builtin_amdgcn_global_load_lds((const unsigned*)((const char*)(gp) + (v1)), (LAS unsigned*)(lds + (bufoff) + ldsw + 8192), 16, 0, 0); } while (0)
#define PG8_LDA(dst, b, h) do { _Pragma("unroll") for (int m = 0; m < 4; ++m) _Pragma("unroll") for (int k = 0; k < 2; ++k) dst[m][k] = *(const LAS bf16x8*)(lds + PG8_SA(b, h) + aoff + m * 2048 + k * 1024); } while (0)
#define PG8_LDB(dst, b, h) do { _Pragma("unroll") for (int n = 0; n < 2; ++n) _Pragma("unroll") for (int k = 0; k < 2; ++k) dst[n][k] = *(const LAS bf16x8*)(lds + PG8_SB(b, h) + boff + n * 2048 + k * 1024); } while (0)
#define PG8_MMA(ai, bj, At, Bt) do { __builtin_amdgcn_s_setprio(1); _Pragma("unroll") for (int m = 0; m < 4; ++m) _Pragma("unroll") for (int n = 0; n < 2; ++n) _Pragma("unroll") for (int k = 0; k < 2; ++k) \
        acc[ai][bj][m][n] = __builtin_amdgcn_mfma_f32_16x16x32_bf16(Bt[n][k], At[m][k], acc[ai][bj][m][n], 0, 0, 0); __builtin_amdgcn_s_setprio(0); } while (0)
#define PG8_WAIT_V(n) asm volatile("s_waitcnt vmcnt(" #n ")" ::: "memory")
#define PG8_WAIT_L(n) asm volatile("s_waitcnt lgkmcnt(" #n ")" ::: "memory")
#define PG8_BAR __builtin_amdgcn_s_barrier()
#define PG8_SCHED __builtin_amdgcn_sched_barrier(0)
#define PG8_BSEL(u, T) ((T) < ksplit ? (const char*)(u).b0 + (size_t)(T) * kstep : (const char*)(u).b1 + (size_t)((T) - ksplit) * kstep)
    Unit cur, nxt; int ui = 0;
    if (!S.next(0, cur)) return;
    f32x4 acc[2][2][4][2];
#pragma unroll
    for (int a = 0; a < 2; ++a)
#pragma unroll
        for (int b = 0; b < 2; ++b)
#pragma unroll
            for (int m = 0; m < 4; ++m)
#pragma unroll
                for (int n = 0; n < 2; ++n) acc[a][b][m][n] = (f32x4){0.f, 0.f, 0.f, 0.f};
    bf16x8 At[4][2], B0[2][2], B1[2][2];
    unsigned va00, va01, va10, va11;
    PG8_AOFFS(cur, va00, va01, va10, va11);
    {
        const char* b0p = PG8_BSEL(cur, 0); const char* b1p = PG8_BSEL(cur, 1);
        PG8_STAGE(PG8_SB(0, 0), b0p, voffB[0], voffB[1]); PG8_STAGE(PG8_SB(0, 1), b0p + hstepB, voffB[0], voffB[1]); PG8_STAGE(PG8_SA(0, 0), Abase, va00, va01); PG8_STAGE(PG8_SA(0, 1), Abase, va10, va11);
        if (wr == 1) PG8_BAR;
        PG8_WAIT_V(2); PG8_BAR;
        PG8_STAGE(PG8_SB(1, 0), b1p, voffB[0], voffB[1]); PG8_STAGE(PG8_SA(1, 0), Abase + kstep, va00, va01); PG8_STAGE(PG8_SB(1, 1), b1p + hstepB, voffB[0], voffB[1]);
        PG8_WAIT_V(6); PG8_BAR;
    }
    for (;;) {
        const bool has_next = S.next(ui + 1, nxt);
        if (!has_next) nxt = cur;
        unsigned na00, na01, na10, na11;
        PG8_AOFFS(nxt, na00, na01, na10, na11);
        for (int t = 0; t < nt; t += 2) {
            const bool last = (t == nt - 2);
            const char* a1 = Abase + (size_t)(t + 1) * kstep;
            const char* a2 = last ? Abase : Abase + (size_t)(t + 2) * kstep; const char* a3 = a2 + kstep;
            const char* b2 = last ? PG8_BSEL(nxt, 0) : PG8_BSEL(cur, t + 2); const char* b3 = last ? PG8_BSEL(nxt, 1) : PG8_BSEL(cur, t + 3);
            const unsigned x00 = last ? na00 : va00, x01 = last ? na01 : va01, x10 = last ? na10 : va10, x11 = last ? na11 : va11;
            PG8_LDB(B0, 0, 0); PG8_LDB(B1, 0, 1); PG8_SCHED; PG8_LDA(At, 0, 0); PG8_STAGE(PG8_SA(1, 1), a1, va10, va11);
            PG8_WAIT_V(8); PG8_WAIT_L(0); PG8_BAR; PG8_MMA(0, 0, At, B0); PG8_MMA(0, 1, At, B1); PG8_BAR; PG8_SCHED;
            PG8_LDA(At, 0, 1); PG8_STAGE(PG8_SB(0, 0), b2, voffB[0], voffB[1]); PG8_STAGE(PG8_SB(0, 1), b2 + hstepB, voffB[0], voffB[1]); PG8_STAGE(PG8_SA(0, 0), a2, x00, x01);
            PG8_WAIT_V(8); PG8_WAIT_L(0); PG8_BAR; PG8_MMA(1, 0, At, B0); PG8_MMA(1, 1, At, B1); PG8_BAR; PG8_SCHED;
            PG8_LDB(B0, 1, 0); PG8_LDB(B1, 1, 1); PG8_SCHED; PG8_LDA(At, 1, 0); PG8_STAGE(PG8_SA(0, 1), a2, x10, x11);
            PG8_WAIT_V(8); PG8_WAIT_L(0); PG8_BAR; PG8_MMA(0, 0, At, B0); PG8_MMA(0, 1, At, B1); PG8_BAR; PG8_SCHED;
            PG8_LDA(At, 1, 1); PG8_STAGE(PG8_SB(1, 0), b3, voffB[0], voffB[1]); PG8_STAGE(PG8_SB(1, 1), b3 + hstepB, voffB[0], voffB[1]); PG8_STAGE(PG8_SA(1, 0), a3, x00, x01);
            PG8_WAIT_V(8); PG8_WAIT_L(0); PG8_BAR; PG8_MMA(1, 0, At, B0); PG8_MMA(1, 1, At, B1); PG8_BAR; PG8_SCHED;
        }
        if constexpr (ALIGN_EPI) { if (wr == 0) PG8_BAR; }
        E(acc, cur, wr, wc, fr, fq);
        if (!has_next) break;
#pragma unroll
        for (int a = 0; a < 2; ++a)
#pragma unroll
            for (int b = 0; b < 2; ++b)
#pragma unroll
                for (int m = 0; m < 4; ++m)
#pragma unroll
                    for (int n = 0; n < 2; ++n) acc[a][b][m][n] = (f32x4){0.f, 0.f, 0.f, 0.f};
        cur = nxt; va00 = na00; va01 = na01; va10 = na10; va11 = na11; ++ui;
        if constexpr (ALIGN_EPI) { if (wr == 1) PG8_BAR; }
    }
    PG8_WAIT_V(0);
    if constexpr (!ALIGN_EPI) { if (wr == 0) PG8_BAR; }
    PG8_BAR;
#undef PG8_SA
#undef PG8_SB
#undef PG8_STAGE
#undef PG8_LDA
#undef PG8_LDB
#undef PG8_MMA
#undef PG8_WAIT_V
#undef PG8_WAIT_L
#undef PG8_BAR
#undef PG8_SCHED
#undef PG8_BSEL
#undef PG8_AOFFS
}

struct DenseSched {
    int nM, nN, nwg, G, c; const bf16_t* Bt; int ldb;
    DI void init(int M, int N, int G_, int c_, const bf16_t* Bt_, int ldb_) { nM = M / BM; nN = N / BM; nwg = nM * nN; G = G_; c = c_; Bt = Bt_; ldb = ldb_; }
    DI bool next(int i, Unit& u) const {
        const long L = (long)i * G + c; if (L >= nwg) return false;
        int wgid = (int)L; { const int q = nwg / NXCD, r = nwg % NXCD, xcd = wgid % NXCD, off = wgid / NXCD; wgid = (xcd < r ? xcd * (q + 1) : r * (q + 1) + (xcd - r) * q) + off; }
        const int nig = WGM * nN, gid = wgid / nig, fm = gid * WGM, gsz = (nM - fm) < WGM ? (nM - fm) : WGM;
        u.pm = fm + ((wgid % nig) % gsz); u.pn = (wgid % nig) / gsz;
        u.arow0 = u.pm * BM; u.acnt = 0; u.alist = nullptr; u.b0 = Bt + (size_t)u.pn * BM * ldb; u.b1 = u.b0; u.e0 = 0; u.e1 = 0; return true;
    }
};
struct MoeSched {
    const unsigned* cnt; const int* lists; const bf16_t* W; int NCT, G, c, mode;
    DI bool next(int i, Unit& u) const {
        int L = i * G + c;
        for (int cl = 0; cl < NCLS; ++cl) {
            const int n = (int)__builtin_amdgcn_readfirstlane((int)cnt[64 * cl]); const int tiles = (n + 255) >> 8, nu = tiles * NCT;
            if (L < nu) {
                const int rt = L / NCT, ct = L % NCT, g = cl / 6, pr = cl % 6;
                const int lo = pr < 3 ? 0 : (pr < 5 ? 1 : 2), hi = pr < 3 ? pr + 1 : (pr < 5 ? pr - 1 : 3);
                u.arow0 = rt * 256; u.acnt = n; u.alist = lists + (size_t)cl * MTOK; u.pm = rt; u.pn = ct; u.e0 = 4 * g + lo; u.e1 = 4 * g + hi;
                if (mode == 1) { const int e = ct < 4 ? u.e0 : u.e1; u.b0 = W + ((size_t)e * 1024 + (size_t)(ct & 3) * 256) * 1024; u.b1 = u.b0; }
                else { u.b0 = W + ((size_t)u.e0 * 1024 + (size_t)ct * 256) * 512; u.b1 = W + ((size_t)u.e1 * 1024 + (size_t)ct * 256) * 512; }
                return true;
            }
            L -= nu;
        }
        return false;
    }
};

struct EpiBf16 {
    static constexpr bool PERM = true;
    bf16_t* O; int ldc; int sc_lo, sc_hi; float scale;
    DI void operator()(const f32x4 (&acc)[2][2][4][2], const Unit& u, int wr, int wc, int fr, int fq) const {
        const int row0 = u.pm * BM + wr * 64 + fr, col0 = u.pn * BM + wc * 32 + 8 * fq;
        const float sc = (u.pn >= sc_lo && u.pn < sc_hi) ? scale : 1.f;
#pragma unroll
        for (int ai = 0; ai < 2; ++ai)
#pragma unroll
            for (int m = 0; m < 4; ++m) { bf16_t* rowp = O + (size_t)(row0 + ai * HALF + m * 16) * ldc + col0;
#pragma unroll
                for (int bj = 0; bj < 2; ++bj) { const f32x4 v0 = acc[ai][bj][m][0] * sc, v1 = acc[ai][bj][m][1] * sc;
                    u32x4 w; w.x = cvtpk(v0[0], v0[1]); w.y = cvtpk(v0[2], v0[3]); w.z = cvtpk(v1[0], v1[1]); w.w = cvtpk(v1[2], v1[3]);
                    *(u32x4*)(rowp + bj * HALF) = w; } }
    }
};
struct EpiRes {
    static constexpr bool PERM = false;
    const float* base; float* out;
    DI void operator()(const f32x4 (&acc)[2][2][4][2], const Unit& u, int wr, int wc, int fr, int fq) const {
        const int col0 = u.pn * BM + wc * 32 + 4 * fq;
#pragma unroll
        for (int ai = 0; ai < 2; ++ai)
#pragma unroll
            for (int m = 0; m < 4; ++m) { const size_t off = (size_t)(u.pm * BM + ai * HALF + wr * 64 + m * 16 + fr) * DM + col0;
#pragma unroll
                for (int bj = 0; bj < 2; ++bj)
#pragma unroll
                    for (int n = 0; n < 2; ++n) { const f32x4 bs = *(const f32x4*)(base + off + bj * HALF + n * 16); *(f32x4*)(out + off + bj * HALF + n * 16) = bs + acc[ai][bj][m][n]; } }
    }
};
struct EpiMoe1 {
    static constexpr bool PERM = true;
    bf16_t* HID; const f32x2* wts;
    DI void operator()(const f32x4 (&acc)[2][2][4][2], const Unit& u, int wr, int wc, int fr, int fq) const {
        const int ct = u.pn, colb = (ct < 4 ? 0 : 512) + 128 * (ct & 3) + wc * 32 + 8 * fq;
#pragma unroll
        for (int ai = 0; ai < 2; ++ai)
#pragma unroll
            for (int m = 0; m < 4; ++m) { const int r = u.arow0 + ai * HALF + wr * 64 + m * 16 + fr;
                if (r < u.acnt) { const int tok = u.alist[r]; const f32x2 w2 = wts[tok]; const float w = ct < 4 ? w2.x : w2.y;
                    float h[8];
#pragma unroll
                    for (int n = 0; n < 2; ++n)
#pragma unroll
                        for (int j = 0; j < 4; ++j) h[4 * n + j] = siluf(acc[ai][0][m][n][j]) * acc[ai][1][m][n][j] * w;
                    u32x4 o; o.x = cvtpk(h[0], h[1]); o.y = cvtpk(h[2], h[3]); o.z = cvtpk(h[4], h[5]); o.w = cvtpk(h[6], h[7]);
                    *(u32x4*)(HID + (size_t)tok * 1024 + colb) = o; } }
    }
};
struct EpiMoe2 {
    static constexpr bool PERM = false;
    float* h;
    DI void operator()(const f32x4 (&acc)[2][2][4][2], const Unit& u, int wr, int wc, int fr, int fq) const {
        const int col0 = u.pn * BM + wc * 32 + 4 * fq;
#pragma unroll
        for (int ai = 0; ai < 2; ++ai)
#pragma unroll
            for (int m = 0; m < 4; ++m) { const int r = u.arow0 + ai * HALF + wr * 64 + m * 16 + fr;
                if (r < u.acnt) { const int tok = u.alist[r]; float* hp = h + (size_t)tok * DM + col0;
#pragma unroll
                    for (int bj = 0; bj < 2; ++bj)
#pragma unroll
                        for (int n = 0; n < 2; ++n) { const f32x4 bs = *(const f32x4*)(hp + bj * HALF + n * 16); *(f32x4*)(hp + bj * HALF + n * 16) = bs + acc[ai][bj][m][n]; } } }
    }
};
struct EpiPle {
    static constexpr bool PERM = false;
    float* h; const bf16_t* pp;
    DI void operator()(const f32x4 (&acc)[2][2][4][2], const Unit& u, int wr, int wc, int fr, int fq) const {
        const int col0 = u.pn * BM + wc * 32 + 4 * fq;
#pragma unroll
        for (int ai = 0; ai < 2; ++ai)
#pragma unroll
            for (int m = 0; m < 4; ++m) { const size_t off = (size_t)(u.pm * BM + ai * HALF + wr * 64 + m * 16 + fr) * DM + col0;
#pragma unroll
                for (int bj = 0; bj < 2; ++bj)
#pragma unroll
                    for (int n = 0; n < 2; ++n) { const size_t o2 = off + bj * HALF + n * 16; const f32x4 bs = *(const f32x4*)(h + o2); const u32x2 pw = *(const u32x2*)(pp + o2); const f32x4 a = acc[ai][bj][m][n];
                        f32x4 r; r[0] = bs[0] + bflo(pw.x) * sigmoidf_(a[0]); r[1] = bs[1] + bfhi(pw.x) * sigmoidf_(a[1]); r[2] = bs[2] + bflo(pw.y) * sigmoidf_(a[2]); r[3] = bs[3] + bfhi(pw.y) * sigmoidf_(a[3]);
                        *(f32x4*)(h + o2) = r; } }
    }
};
}

#define XB_TMO      128
#define XB_XCNT(j)  (256  + 64 * (j))
#define XB_XSUB(j)  (1280 + 64 * (j))
#define XB_XGEN(j)  (2304 + 64 * (j))
#define XB_TOP      3328
#define XB_TOPGEN   3392
#define XCD_BAR_WORDS 3456
#define XB_SPIN_CAP (1u << 18)
DI unsigned xb_ld(unsigned* p)              { return __hip_atomic_load(p, __ATOMIC_RELAXED, __HIP_MEMORY_SCOPE_AGENT); }
DI unsigned xb_add(unsigned* p, unsigned v) { return __hip_atomic_fetch_add(p, v, __ATOMIC_RELAXED, __HIP_MEMORY_SCOPE_AGENT); }
DI unsigned xb_xcc_id() { return (unsigned)__builtin_amdgcn_s_getreg((3 << 11) | 20) & 0xFu; }
#define XB_SPIN(cond, bar) do { unsigned _sp = 0; while (cond) { __builtin_amdgcn_s_sleep(1); \
    if ((++_sp & 255u) == 0u) { if (xb_ld(&(bar)[XB_TMO])) break; if (_sp > XB_SPIN_CAP) { atomicAdd(&(bar)[XB_TMO], 1u); break; } } } } while (0)
struct XcdBarrier { unsigned* bar; unsigned x; volatile LAS unsigned* st; };
DI XcdBarrier xcd_barrier_post(unsigned* bar, volatile LAS unsigned* st) {
    XcdBarrier b; b.bar = bar; b.x = xb_xcc_id(); b.st = st;
    if (threadIdx.x == 0) (void)xb_add(&bar[XB_XCNT(b.x)], 1u);
    return b;
}
DI void xcd_barrier_complete(unsigned* bar, unsigned x, unsigned& nloc, unsigned& nx) {
    const unsigned G = gridDim.x * gridDim.y * gridDim.z;
    unsigned sum, cnt, mine, sp = 0u;
    for (;;) {
        sum = 0u; cnt = 0u; mine = 0u;
#pragma unroll
        for (unsigned j = 0; j < 16; ++j) { const unsigned c = xb_ld(&bar[XB_XCNT(j)]); sum += c; cnt += (c > 0u) ? 1u : 0u; mine = (j == x) ? c : mine; }
        if (sum == G) break;
        __builtin_amdgcn_s_sleep(1);
        if ((++sp & 255u) == 0u) { if (xb_ld(&bar[XB_TMO])) break; if (sp > XB_SPIN_CAP) { atomicAdd(&bar[XB_TMO], 1u); break; } }
    }
    nloc = mine > 0u ? mine : 1u; nx = cnt > 0u ? cnt : 1u;
}
DI void xcd_barrier(const XcdBarrier& b) {
    asm volatile("s_waitcnt vmcnt(0)" ::: "memory");
    __syncthreads();
    if (threadIdx.x == 0) {
        unsigned* bar = b.bar;
        __builtin_amdgcn_s_waitcnt(0);
        unsigned nloc = b.st[0], nx = b.st[1];
        if (nloc == 0u) { xcd_barrier_complete(bar, b.x, nloc, nx); b.st[0] = nloc; b.st[1] = nx; }
        const unsigned old = xb_add(&bar[XB_XSUB(b.x)], 1u);
        const unsigned gen = old / nloc;
        if (old + 1u == (gen + 1u) * nloc) {
            __builtin_amdgcn_fence(__ATOMIC_RELEASE, "agent");
            asm volatile("s_waitcnt vmcnt(0)" ::: "memory");
            const unsigned og = xb_add(&bar[XB_TOP], 1u);
            const unsigned tg = og / nx;
            if (og + 1u == (tg + 1u) * nx) xb_add(&bar[XB_TOPGEN], 1u);
            else XB_SPIN(xb_ld(&bar[XB_TOPGEN]) == tg, bar);
            __builtin_amdgcn_fence(__ATOMIC_ACQUIRE, "agent");
            xb_add(&bar[XB_XGEN(b.x)], 1u);
            asm volatile("s_waitcnt vmcnt(0)" ::: "memory");
        } else {
            XB_SPIN(xb_ld(&bar[XB_XGEN(b.x)]) == gen, bar);
            __builtin_amdgcn_fence(__ATOMIC_ACQUIRE, "agent");
            asm volatile("s_waitcnt vmcnt(0)" ::: "memory");
        }
    }
    __syncthreads();
}

struct Args { const float* in[24]; float* out; unsigned char* ws; int ph_lo, ph_hi; };

DI void p0_transpose_item(const float* W, int ldw, int src_n0, int k0, bf16_t* WT, int ldt, int dst_row0, LAS float* scr, int lane) {
#pragma unroll 8
    for (int i = 0; i < 32; ++i) { const int kk = 2 * i + (lane >> 5); scr[kk * 33 + (lane & 31)] = W[(size_t)(k0 + kk) * ldw + src_n0 + (lane & 31)]; }
    asm volatile("s_waitcnt lgkmcnt(0)" ::: "memory");
    const int c = lane & 7;
#pragma unroll
    for (int j = 0; j < 4; ++j) { const int n = (lane >> 3) + 8 * j; const LAS float* s = scr + (8 * c) * 33 + n;
        u32x4 o; o.x = cvtpk(s[0 * 33], s[1 * 33]); o.y = cvtpk(s[2 * 33], s[3 * 33]); o.z = cvtpk(s[4 * 33], s[5 * 33]); o.w = cvtpk(s[6 * 33], s[7 * 33]);
        *(u32x4*)(WT + (size_t)(dst_row0 + n) * ldt + k0 + 8 * c) = o; }
    asm volatile("s_waitcnt lgkmcnt(0)" ::: "memory");
}
DI void rms_row_to_bf16(const float* xrow, const float* g, bf16_t* orow, int lane) {
    const f32x4* xr = (const f32x4*)xrow + lane; const f32x4* gr = (const f32x4*)g + lane;
    f32x4 v[4]; float s = 0.f;
#pragma unroll
    for (int j = 0; j < 4; ++j) { v[j] = xr[64 * j]; s += (v[j].x * v[j].x + v[j].y * v[j].y) + (v[j].z * v[j].z + v[j].w * v[j].w); }
    const float rstd = rsqrtf(wave_sum(s) * (1.f / DM) + EPS);
    unsigned long long* o8 = (unsigned long long*)orow + lane;
#pragma unroll
    for (int j = 0; j < 4; ++j) { const f32x4 gg = gr[64 * j]; o8[64 * j] = (unsigned long long)cvtpk(v[j].x * rstd * gg.x, v[j].y * rstd * gg.y) | ((unsigned long long)cvtpk(v[j].z * rstd * gg.z, v[j].w * rstd * gg.w) << 32); }
}
DI void phase_prologue(const Args& a, LAS unsigned char* lds, int vcu, int G, int tid, int lane, int wave) {
    unsigned char* ws = a.ws;
    LAS float* scr = (LAS float*)(lds + wave * 16384);
    const int gw = vcu * 8 + wave, NGW = G * 8;
    bf16_t* Win = (bf16_t*)(ws + WS_WIN); bf16_t* Wout = (bf16_t*)(ws + WS_WOUT); bf16_t* Wgu = (bf16_t*)(ws + WS_WGU); bf16_t* Wd = (bf16_t*)(ws + WS_WD);
    bf16_t* Wpp = (bf16_t*)(ws + WS_WPP); bf16_t* Wpg = (bf16_t*)(ws + WS_WPG);
    constexpr int I_IN = 16 * 48, I_OUT = 16 * 32, I_G = 16 * 16 * 16, I_D = 16 * 8 * 32, I_PP = 4 * 32, I_PG = 16 * 32;
    constexpr int NITEMS = 2 * I_IN + I_OUT + 2 * I_G + I_D + I_PP + I_PG;
    for (int it = gw; it < NITEMS; it += NGW) {
        int r = it;
        if (r < I_IN) { const int kb = r / 48, nb = r % 48; p0_transpose_item(a.in[2], 3088, 32 * nb, 64 * kb, Win, 1024, 32 * nb, scr, lane); continue; } r -= I_IN;
        if (r < I_IN) { const int kb = r / 48, nb = r % 48; p0_transpose_item(a.in[2], 3088, 1544 + 32 * nb, 64 * kb, Win, 1024, 1536 + 32 * nb, scr, lane); continue; } r -= I_IN;
        if (r < I_OUT) { const int kb = r / 32, nb = r % 32; p0_transpose_item(a.in[10], 1024, 32 * nb, 64 * kb, Wout, 1024, 32 * nb, scr, lane); continue; } r -= I_OUT;
        if (r < 2 * I_G) { const int up = r >= I_G; if (up) r -= I_G; const int e = r / 256, q = r % 256, kb = q / 16, nb = q % 16, n0 = 32 * nb;
            p0_transpose_item(a.in[up ? 18 : 17] + (size_t)e * 1024 * 512, 512, n0, 64 * kb, Wgu + (size_t)e * 1024 * 1024, 1024, (n0 >> 7) * 256 + (n0 & 127) + (up ? 128 : 0), scr, lane); continue; } r -= 2 * I_G;
        if (r < I_D) { const int e = r / 256, q = r % 256, kb = q / 32, nb = q % 32; p0_transpose_item(a.in[19] + (size_t)e * 512 * 1024, 1024, 32 * nb, 64 * kb, Wd + (size_t)e * 1024 * 512, 512, 32 * nb, scr, lane); continue; } r -= I_D;
        if (r < I_PP) { const int kb = r / 32, nb = r % 32; p0_transpose_item(a.in[21], 1024, 32 * nb, 64 * kb, Wpp, 256, 32 * nb, scr, lane); continue; } r -= I_PP;
        { const int kb = r / 32, nb = r % 32; p0_transpose_item(a.in[22], 1024, 32 * nb, 64 * kb, Wpg, 1024, 32 * nb, scr, lane); }
    }
    { bf16_t* W16 = (bf16_t*)(ws + WS_W16); const int gt = vcu * 512 + tid, NT = G * 512;
      for (int idx = gt; idx < 16 * 1024; idx += NT) { const int c = idx >> 10, k = idx & 1023; const int col = c < 8 ? 1536 + c : 3080 + (c - 8); W16[idx] = cvt1(a.in[2][(size_t)k * 3088 + col]); } }
    { const f32x4* p4 = (const f32x4*)a.in[1]; u32x2* pb = (u32x2*)(ws + WS_PB); const int gt = vcu * 512 + tid, NT = G * 512;
      for (int idx = gt; idx < MTOK * 256 / 4; idx += NT) { const f32x4 v = p4[idx]; u32x2 o; o.x = cvtpk(v.x, v.y); o.y = cvtpk(v.z, v.w); pb[idx] = o; } }
    { bf16_t* XN = (bf16_t*)(ws + WS_XN); for (int m = gw; m < MTOK; m += NGW) rms_row_to_bf16(a.in[0] + (size_t)m * DM, a.in[11], XN + (size_t)m * DM, lane); }
}

DI void phase_dtf(const Args& a, int vcu, int G, int lane, int wave) {
    const bf16_t* XN = (const bf16_t*)(a.ws + WS_XN); const bf16_t* W16 = (const bf16_t*)(a.ws + WS_W16); float* DTF = (float*)(a.ws + WS_DTF);
    const int fr = lane & 15, fq = lane >> 4;
    for (int rb = vcu * 8 + wave; rb < MTOK / 16; rb += G * 8) {
        const int row0 = rb * 16; f32x4 acc = {0.f, 0.f, 0.f, 0.f};
        const bf16_t* ap = XN + (size_t)(row0 + fr) * DM + 8 * fq; const bf16_t* bp = W16 + (size_t)fr * DM + 8 * fq;
#pragma unroll 8
        for (int i = 0; i < 32; ++i) { const bf16x8 av = *(const bf16x8*)(ap + 32 * i), bv = *(const bf16x8*)(bp + 32 * i); acc = __builtin_amdgcn_mfma_f32_16x16x32_bf16(av, bv, acc, 0, 0, 0); }
#pragma unroll
        for (int j = 0; j < 4; ++j) DTF[(size_t)(row0 + 4 * fq + j) * 16 + fr] = acc[j];
    }
}

DI void phase_fcb(const Args& a, int vcu, int G, int lane, int wave) {
    const float* DTF = (const float*)(a.ws + WS_DTF); float* FCB = (float*)(a.ws + WS_FCB);
    for (int bh = vcu * 8 + wave; bh < NB * NHEAD; bh += G * 8) {
        const int b = bh >> 3, h = bh & 7; const float fb = a.in[9][h]; float carry = 0.f;
        for (int c = 0; c < SEQ / 64; ++c) {
            const int t = c * 64 + lane; const float y = DTF[(size_t)(b * SEQ + t) * 16 + 8 + h] + fb;
            float v = -(fminf(y, 0.f) - log1pf(__expf(-fabsf(y)))) * LOG2E;
#pragma unroll
            for (int o = 1; o < 64; o <<= 1) { const float n = __shfl_up(v, o); if (lane >= o) v += n; }
            v += carry; FCB[(size_t)bh * SEQ + t] = v; carry = __shfl(v, 63);
        }
    }
}

constexpr int S_XT = 0, S_BN = 65536, S_CN = 98304, S_BT = 65536;
constexpr int AUX_DT = 0, AUX_ACS = 2048, AUX_EACS = 4096, AUX_SC = 6144;
template <int MODE> DI void ssd_prep(const Args& a, LAS unsigned char* lds, int b, int c, int tid, int lane, int wave) {
    asm volatile("" : "+v"(tid), "+v"(lane));
    const bf16_t* PROJ = (const bf16_t*)(a.ws + WS_PROJ); const float* DTF = (const float*)(a.ws + WS_DTF);
    LAS float* aux = (LAS float*)(lds + AUX_OFF);
    const int t0 = b * SEQ + c * CH;
    {
        const int h = wave; const float dtr = DTF[(size_t)(t0 + lane) * 16 + h] + a.in[5][h];
        const float dt = softplusf_(dtr), av = -__expf(a.in[6][h]); float acs = dt * av;
#pragma unroll
        for (int o = 1; o < 64; o <<= 1) { const float n = __shfl_up(acs, o); if (lane >= o) acs += n; }
        const float tot = __shfl(acs, 63);
        aux[(AUX_DT >> 2) + h * 64 + lane] = dt; aux[(AUX_ACS >> 2) + h * 64 + lane] = acs; aux[(AUX_EACS >> 2) + h * 64 + lane] = __expf(acs);
        aux[(AUX_SC >> 2) + h * 64 + lane] = (MODE == 1) ? dt * __expf(tot - acs) : dt;
        if (MODE == 1 && lane == 0) ((float*)(a.ws + WS_CD))[(size_t)(b * NCHUNK + c) * 8 + h] = __expf(tot);
    }
    __syncthreads();
    const int cg = tid & 127, lq = tid >> 7;
    if (MODE == 1 && cg >= 96) return;
    const int ch0 = cg * 8;
    float cw[4][8], cb[8];
#pragma unroll
    for (int k = 0; k < 4; ++k) { const f32x4 w0 = *(const f32x4*)(a.in[3] + k * 1024 + ch0), w1 = *(const f32x4*)(a.in[3] + k * 1024 + ch0 + 4);
        cw[k][0] = w0.x; cw[k][1] = w0.y; cw[k][2] = w0.z; cw[k][3] = w0.w; cw[k][4] = w1.x; cw[k][5] = w1.y; cw[k][6] = w1.z; cw[k][7] = w1.w; }
    { const f32x4 b0 = *(const f32x4*)(a.in[4] + ch0), b1 = *(const f32x4*)(a.in[4] + ch0 + 4); cb[0] = b0.x; cb[1] = b0.y; cb[2] = b0.z; cb[3] = b0.w; cb[4] = b1.x; cb[5] = b1.y; cb[6] = b1.z; cb[7] = b1.w; }
    const int l0 = 16 * lq, pos0 = c * CH + l0;
    const bf16_t* src = PROJ + (size_t)(t0 + l0) * NPROJ + PC_XBC + ch0;
    u32x4 win[3];
#pragma unroll
    for (int k = 0; k < 3; ++k) win[k] = (pos0 - 3 + k >= 0) ? *(const u32x4*)(src + (ptrdiff_t)(k - 3) * NPROJ) : (u32x4){0u, 0u, 0u, 0u};
    const bool is_x = cg < 64; const int hh = cg >> 3;
#pragma unroll
    for (int half = 0; half < 2; ++half) {
        unsigned pk[8][4];
#pragma unroll
        for (int jj = 0; jj < 8; ++jj) {
            const int l = l0 + half * 8 + jj; const u32x4 curv = *(const u32x4*)(src + (size_t)(half * 8 + jj) * NPROJ);
            float v[8];
#pragma unroll
            for (int e = 0; e < 4; ++e) {
                const unsigned w0 = win[0][e], w1 = win[1][e], w2 = win[2][e], w3 = curv[e];
                v[2 * e] = cb[2 * e] + cw[0][2 * e] * bflo(w0) + cw[1][2 * e] * bflo(w1) + cw[2][2 * e] * bflo(w2) + cw[3][2 * e] * bflo(w3);
                v[2 * e + 1] = cb[2 * e + 1] + cw[0][2 * e + 1] * bfhi(w0) + cw[1][2 * e + 1] * bfhi(w1) + cw[2][2 * e + 1] * bfhi(w2) + cw[3][2 * e + 1] * bfhi(w3);
            }
            win[0] = win[1]; win[1] = win[2]; win[2] = curv;
            const float sc = is_x ? aux[(AUX_SC >> 2) + hh * 64 + l] : 1.f;
#pragma unroll
            for (int e = 0; e < 8; ++e) v[e] = siluf(v[e]) * sc;
            const bool transposed = is_x || (MODE == 1);
            if (transposed) {
#pragma unroll
                for (int e = 0; e < 8; ++e) { const unsigned hb = cvtpk(v[e], 0.f) & 0xffffu; if (jj & 1) pk[e][jj >> 1] |= hb << 16; else pk[e][jj >> 1] = hb; }
            } else {
                const int q = cg - 64, isC = q >= 32, qq = q & 31, gidx = qq >> 4, n0 = (qq & 15) * 8;
                u32x4 o; o.x = cvtpk(v[0], v[1]); o.y = cvtpk(v[2], v[3]); o.z = cvtpk(v[4], v[5]); o.w = cvtpk(v[6], v[7]);
                *(LAS u32x4*)(lds + (isC ? S_CN : S_BN) + gidx * 16384 + l * 256 + n0 * 2) = o;
            }
        }
        if (is_x) {
            const int p0 = (cg & 7) * 8;
#pragma unroll
            for (int e = 0; e < 8; ++e) *(LAS u32x4*)(lds + S_XT + hh * 8192 + (p0 + e) * 128 + (l0 + half * 8) * 2) = (u32x4){pk[e][0], pk[e][1], pk[e][2], pk[e][3]};
        } else if (MODE == 1) {
            const int q = cg - 64, gidx = q >> 4, n0 = (q & 15) * 8;
#pragma unroll
            for (int e = 0; e < 8; ++e) *(LAS u32x4*)(lds + S_BT + gidx * 16384 + (n0 + e) * 128 + (l0 + half * 8) * 2) = (u32x4){pk[e][0], pk[e][1], pk[e][2], pk[e][3]};
        }
    }
}
DI void phase_ssd_states(const Args& a, LAS unsigned char* lds, int vcu, int G, int tid, int lane, int wave) {
    bf16_t* ST = (bf16_t*)(a.ws + WS_ST);
    for (int u = vcu; u < NB * NCHUNK; u += G) {
        const int b = u / NCHUNK, c = u % NCHUNK;
        ssd_prep<1>(a, lds, b, c, tid, lane, wave);
        __syncthreads();
        int lane_ = lane; asm volatile("" : "+v"(lane_)); const int r32 = lane_ & 31, h2 = lane_ >> 5;
        const int h = wave, g = h >> 2;
        f32x16 acc[2][4];
#pragma unroll
        for (int i = 0; i < 2; ++i)
#pragma unroll
            for (int j = 0; j < 4; ++j) acc[i][j] = (f32x16){};
#pragma unroll
        for (int ks = 0; ks < 4; ++ks) {
            bf16x8 af[2], bfr[4];
#pragma unroll
            for (int pb = 0; pb < 2; ++pb) af[pb] = *(const LAS bf16x8*)(lds + S_XT + h * 8192 + (32 * pb + r32) * 128 + (16 * ks + 8 * h2) * 2);
#pragma unroll
            for (int nb = 0; nb < 4; ++nb) bfr[nb] = *(const LAS bf16x8*)(lds + S_BT + g * 16384 + (32 * nb + r32) * 128 + (16 * ks + 8 * h2) * 2);
#pragma unroll
            for (int pb = 0; pb < 2; ++pb)
#pragma unroll
                for (int nb = 0; nb < 4; ++nb) acc[pb][nb] = MFMA32(af[pb], bfr[nb], acc[pb][nb]);
        }
        bf16_t* dst = ST + ((size_t)(b * NCHUNK + c) * 8 + h) * 8192;
#pragma unroll
        for (int pb = 0; pb < 2; ++pb)
#pragma unroll
            for (int nb = 0; nb < 4; ++nb)
#pragma unroll
                for (int i = 0; i < 16; ++i) dst[(32 * pb + crow(i, h2)) * 128 + 32 * nb + r32] = cvt1(acc[pb][nb][i]);
        __syncthreads();
    }
}
DI void phase_ssd_scan(const Args& a, int vcu, int G, int tid) {
    bf16_t* ST = (bf16_t*)(a.ws + WS_ST); const float* CD = (const float*)(a.ws + WS_CD);
    for (int idx = vcu * 512 + tid; idx < NB * NHEAD * 2048; idx += G * 512) {
        const int bh = idx >> 11, e4 = idx & 2047, b = bh >> 3, h = bh & 7;
        float cr[4] = {0.f, 0.f, 0.f, 0.f};
        for (int c0 = 0; c0 < NCHUNK; c0 += 8) {
            u32x2 st[8]; float cd[8];
#pragma unroll
            for (int j = 0; j < 8; ++j) { st[j] = *(const u32x2*)(ST + ((size_t)(b * NCHUNK + c0 + j) * 8 + h) * 8192 + e4 * 4); cd[j] = CD[(size_t)(b * NCHUNK + c0 + j) * 8 + h]; }
#pragma unroll
            for (int j = 0; j < 8; ++j) {
                u32x2 o; o.x = cvtpk(cr[0], cr[1]); o.y = cvtpk(cr[2], cr[3]);
                *(u32x2*)(ST + ((size_t)(b * NCHUNK + c0 + j) * 8 + h) * 8192 + e4 * 4) = o;
                cr[0] = cr[0] * cd[j] + bflo(st[j].x); cr[1] = cr[1] * cd[j] + bfhi(st[j].x); cr[2] = cr[2] * cd[j] + bflo(st[j].y); cr[3] = cr[3] * cd[j] + bfhi(st[j].y);
            }
        }
    }
}
DI void phase_ssd_out(const Args& a, LAS unsigned char* lds, int vcu, int G, int tid, int lane, int wave) {
    const bf16_t* PREV = (const bf16_t*)(a.ws + WS_ST); const bf16_t* PROJ = (const bf16_t*)(a.ws + WS_PROJ); bf16_t* MIX = (bf16_t*)(a.ws + WS_MIX);
    LAS float* aux = (LAS float*)(lds + AUX_OFF);
    for (int u = vcu; u < NB * NCHUNK; u += G) {
        const int b = u / NCHUNK, c = u % NCHUNK, t0 = b * SEQ + c * CH;
        ssd_prep<2>(a, lds, b, c, tid, lane, wave);
        __syncthreads();
        int lane_ = lane, tid_ = tid; asm volatile("" : "+v"(lane_), "+v"(tid_)); const int r32 = lane_ & 31, h2 = lane_ >> 5;
        const int h = wave, g = h >> 2; const float Dh = a.in[7][h];
        const LAS unsigned char* bnb = lds + S_BN + g * 16384 + r32 * 256 + h2 * 16;
        const LAS unsigned char* cnb = lds + S_CN + g * 16384 + r32 * 256 + h2 * 16;
        const LAS unsigned char* xtb = lds + S_XT + h * 8192 + r32 * 128 + h2 * 8;
        const LAS float* auxl = aux + h * 64 + r32;
        const LAS float* auxs = aux + h * 64 + 4 * h2;
        asm volatile("" : "+v"(bnb), "+v"(cnb), "+v"(xtb), "+v"(auxl), "+v"(auxs));
        f32x16 yd[2][2];
#pragma unroll
        for (int i = 0; i < 2; ++i)
#pragma unroll
            for (int j = 0; j < 2; ++j) yd[i][j] = (f32x16){};
#pragma unroll
        for (int blk = 0; blk < 3; ++blk) {
            const int sb = blk == 2 ? 1 : 0, lb = blk == 0 ? 0 : 1;
            f32x16 X = (f32x16){};
#pragma unroll
            for (int ks = 0; ks < 8; ++ks) {
                const bf16x8 af = *(const LAS bf16x8*)(bnb + 8192 * sb + 32 * ks);
                const bf16x8 bfr = *(const LAS bf16x8*)(cnb + 8192 * lb + 32 * ks);
                X = MFMA32(af, bfr, X);
            }
            const int l = 32 * lb + r32; const float al = auxl[(AUX_ACS >> 2) + 32 * lb], dsk = Dh / auxl[(AUX_DT >> 2) + 32 * lb];
#pragma unroll
            for (int i = 0; i < 16; ++i) { const int s = 32 * sb + crow(i, h2); const float as = auxs[(AUX_ACS >> 2) + 32 * sb + 8 * (i >> 2) + (i & 3)];
                float v = (s <= l) ? X[i] * __expf(al - as) : 0.f; if (s == l) v += dsk; X[i] = v; }
#pragma unroll
            for (int ks2 = 0; ks2 < 2; ++ks2) { const bf16x8 xa = pack8(X, ks2);
#pragma unroll
                for (int pb = 0; pb < 2; ++pb) {
                    const LAS unsigned char* bp = xtb + 4096 * pb + 64 * sb + 32 * ks2;
                    const s16x4 lo = *(const LAS s16x4*)bp, hi = *(const LAS s16x4*)(bp + 16);
                    const bf16x8 bv = __builtin_shufflevector(lo, hi, 0, 1, 2, 3, 4, 5, 6, 7);
                    yd[lb][pb] = MFMA32(xa, bv, yd[lb][pb]);
                } }
        }
        const bf16_t* pv = PREV + ((size_t)(b * NCHUNK + c) * 8 + h) * 8192 + r32 * 128 + 8 * h2;
#pragma unroll
        for (int lb = 0; lb < 2; ++lb)
#pragma unroll
            for (int pb = 0; pb < 2; ++pb) {
                f32x16 yo = (f32x16){};
#pragma unroll
                for (int ks = 0; ks < 8; ++ks) {
                    const bf16x8 af = *(const LAS bf16x8*)(cnb + 8192 * lb + 32 * ks);
                    const bf16x8 bfr = *(const bf16x8*)(pv + 4096 * pb + 16 * ks);
                    yo = MFMA32(af, bfr, yo);
                }
#pragma unroll
                for (int i = 0; i < 16; ++i) yd[lb][pb][i] += auxs[(AUX_EACS >> 2) + 32 * lb + 8 * (i >> 2) + (i & 3)] * yo[i];
            }
        __syncthreads();
#pragma unroll
        for (int lb = 0; lb < 2; ++lb)
#pragma unroll
            for (int pb = 0; pb < 2; ++pb)
#pragma unroll
                for (int i = 0; i < 16; ++i) *(LAS bf16_t*)(lds + (32 * lb + crow(i, h2)) * 1024 + (h * 64 + 32 * pb + r32) * 2) = cvt1(yd[lb][pb][i]);
        __syncthreads();
        {
            const int l = tid_ >> 3, c0 = (tid_ & 7) * 64; const size_t row = (size_t)(t0 + l);
            float yg[64]; float ss = 0.f;
#pragma unroll
            for (int q = 0; q < 8; ++q) {
                const u32x4 yv = *(const LAS u32x4*)(lds + l * 1024 + (c0 + 8 * q) * 2); const u32x4 zv = *(const u32x4*)(PROJ + row * NPROJ + PC_Z + c0 + 8 * q);
#pragma unroll
                for (int e = 0; e < 4; ++e) { const float y0 = bflo(yv[e]) * siluf(bflo(zv[e])), y1 = bfhi(yv[e]) * siluf(bfhi(zv[e])); yg[8 * q + 2 * e] = y0; yg[8 * q + 2 * e + 1] = y1; ss += y0 * y0 + y1 * y1; }
            }
            ss += __shfl_xor(ss, 1); ss += __shfl_xor(ss, 2); ss += __shfl_xor(ss, 4);
            const float rstd = rsqrtf(ss * (1.f / 512.f) + EPS);
#pragma unroll
            for (int q = 0; q < 8; ++q) { const f32x4 g0 = *(const f32x4*)(a.in[8] + c0 + 8 * q), g1 = *(const f32x4*)(a.in[8] + c0 + 8 * q + 4);
                u32x4 o; o.x = cvtpk(yg[8 * q] * rstd * g0.x, yg[8 * q + 1] * rstd * g0.y); o.y = cvtpk(yg[8 * q + 2] * rstd * g0.z, yg[8 * q + 3] * rstd * g0.w);
                o.z = cvtpk(yg[8 * q + 4] * rstd * g1.x, yg[8 * q + 5] * rstd * g1.y); o.w = cvtpk(yg[8 * q + 6] * rstd * g1.z, yg[8 * q + 7] * rstd * g1.w);
                *(u32x4*)(MIX + row * DM + c0 + 8 * q) = o; }
        }
        __syncthreads();
    }
}

constexpr int A_K = 0, A_KROW = 144, A_VT = 9216, A_VROW = 136, A_G = 9216 + 8704, A_WS = A_G + 256;
DI void attn_unit(const Args& a, LAS unsigned char* lds, int b, int h, int qb, int tid, int lane, int wave) {
    const bf16_t* PROJ = (const bf16_t*)(a.ws + WS_PROJ); const float* FCB = (const float*)(a.ws + WS_FCB) + (size_t)(b * 8 + h) * SEQ; bf16_t* MIX = (bf16_t*)(a.ws + WS_MIX);
    asm volatile("" : "+v"(tid), "+v"(lane));
    const int r32 = lane & 31, h2 = lane >> 5; const int q0 = qb * 256, qw0 = q0 + 32 * wave; const size_t rowbase = (size_t)b * SEQ;
    bf16x8 qf[4];
#pragma unroll
    for (int ds = 0; ds < 4; ++ds) qf[ds] = *(const bf16x8*)(PROJ + (rowbase + qw0 + r32) * NPROJ + PC_Q + h * 64 + 16 * ds + 8 * h2);
    f32x16 o0 = (f32x16){}, o1 = (f32x16){}; float mrun = -INFINITY, lrun = 0.f;
    LAS float* wsf = (LAS float*)(lds + A_WS) + wave * 32; LAS float* gt = (LAS float*)(lds + A_G);
    const int NT = (q0 + 256) / 64, t_start = 0;
    const int srow = tid >> 3, sch = tid & 7;
    const bf16_t* kp = PROJ + (rowbase + srow) * NPROJ + PC_K + h * 64 + sch * 8; const bf16_t* vp = PROJ + (rowbase + srow) * NPROJ + PC_V + h * 64 + sch * 8;
    u32x4 kr = *(const u32x4*)(kp + (size_t)t_start * 64 * NPROJ), vr = *(const u32x4*)(vp + (size_t)t_start * 64 * NPROJ); float gr = tid < 64 ? FCB[t_start * 64 + tid] : 0.f;
    for (int t = t_start; t < NT; ++t) {
        __syncthreads();
        *(LAS u32x4*)(lds + A_K + srow * A_KROW + sch * 16) = kr;
#pragma unroll
        for (int e = 0; e < 4; ++e) { *(LAS bf16_t*)(lds + A_VT + (sch * 8 + 2 * e) * A_VROW + srow * 2) = (bf16_t)(vr[e] & 0xffffu); *(LAS bf16_t*)(lds + A_VT + (sch * 8 + 2 * e + 1) * A_VROW + srow * 2) = (bf16_t)(vr[e] >> 16); }
        if (tid < 64) gt[tid] = gr;
        __syncthreads();
        if (t + 1 < NT) { kr = *(const u32x4*)(kp + (size_t)(t + 1) * 64 * NPROJ); vr = *(const u32x4*)(vp + (size_t)(t + 1) * 64 * NPROJ); if (tid < 64) gr = FCB[(t + 1) * 64 + tid]; }
        if (64 * t > qw0 + 31) continue;
        f32x16 p0 = (f32x16){}, p1 = (f32x16){};
#pragma unroll
        for (int ds = 0; ds < 4; ++ds) {
            const bf16x8 k0 = *(const LAS bf16x8*)(lds + A_K + r32 * A_KROW + (16 * ds + 8 * h2) * 2), k1 = *(const LAS bf16x8*)(lds + A_K + (32 + r32) * A_KROW + (16 * ds + 8 * h2) * 2);
            p0 = MFMA32(k0, qf[ds], p0); p1 = MFMA32(k1, qf[ds], p1);
        }
        const bool diag = 64 * t + 63 > qw0; const int qg = qw0 + r32;
        float mx = -INFINITY;
#pragma unroll
        for (int i = 0; i < 16; ++i) { const int kv = crow(i, h2); float s0 = p0[i] + gt[kv], s1 = p1[i] + gt[kv + 32];
            if (diag) { if (64 * t + kv > qg) s0 = -INFINITY; if (64 * t + kv + 32 > qg) s1 = -INFINITY; }
            p0[i] = s0; p1[i] = s1; mx = fmaxf(mx, fmaxf(s0, s1)); }
        mx = fmaxf(mx, __shfl_xor(mx, 32));
        const float mnew = fmaxf(mrun, mx), alpha = exp2f(mrun - mnew); mrun = mnew;
        float rs = 0.f;
#pragma unroll
        for (int i = 0; i < 16; ++i) { p0[i] = exp2f(p0[i] - mnew); p1[i] = exp2f(p1[i] - mnew); rs += p0[i] + p1[i]; }
        lrun = lrun * alpha + rs;
        if (h2 == 0) wsf[r32] = alpha;
        asm volatile("s_waitcnt lgkmcnt(0)" ::: "memory");
#pragma unroll
        for (int i = 0; i < 16; ++i) { const float f = wsf[crow(i, h2)]; o0[i] *= f; o1[i] *= f; }
#pragma unroll
        for (int kb = 0; kb < 2; ++kb)
#pragma unroll
            for (int ks2 = 0; ks2 < 2; ++ks2) { const bf16x8 pa = pack8(kb ? p1 : p0, ks2);
#pragma unroll
                for (int db = 0; db < 2; ++db) {
                    const LAS unsigned char* bp = lds + A_VT + (32 * db + r32) * A_VROW + (32 * kb + 16 * ks2 + 4 * h2) * 2;
                    const s16x4 lo = *(const LAS s16x4*)bp, hi = *(const LAS s16x4*)(bp + 16);
                    const bf16x8 bv = __builtin_shufflevector(lo, hi, 0, 1, 2, 3, 4, 5, 6, 7);
                    if (db == 0) o0 = MFMA32(pa, bv, o0); else o1 = MFMA32(pa, bv, o1);
                } }
    }
    lrun += __shfl_xor(lrun, 32);
    asm volatile("s_waitcnt lgkmcnt(0)" ::: "memory");
    if (h2 == 0) wsf[r32] = 1.f / lrun;
    asm volatile("s_waitcnt lgkmcnt(0)" ::: "memory");
    bf16_t* op = MIX + (rowbase + qw0) * DM + 512 + h * 64;
#pragma unroll
    for (int i = 0; i < 16; ++i) { const int r = crow(i, h2); const float f = wsf[r]; op[(size_t)r * DM + r32] = cvt1(o0[i] * f); op[(size_t)r * DM + 32 + r32] = cvt1(o1[i] * f); }
}
DI void phase_attn(const Args& a, LAS unsigned char* lds, int vcu, int G, int tid, int lane, int wave) {
    for (int v = vcu; v < 256; v += G)
        for (int j = 0; j < 4; ++j) {
            const int bh = v & 63, k = v >> 6;
            const int qb = j == 0 ? k : (j == 1 ? 7 - k : (j == 2 ? 8 + k : 15 - k));
            attn_unit(a, lds, bh >> 3, bh & 7, qb, tid, lane, wave);
            __syncthreads();
        }
}

DI void phase_route(const Args& a, LAS unsigned char* lds, int vcu, int G, int tid, int lane, int wave) {
    const float* H = a.out; bf16_t* HN = (bf16_t*)(a.ws + WS_XN); unsigned* ctl = (unsigned*)(a.ws + WS_CTL); int* lists = (int*)(a.ws + WS_LIST); f32x2* wts = (f32x2*)(a.ws + WS_WTS);
    LAS float* rw = (LAS float*)lds;
    for (int idx = tid; idx < 1024 * 20; idx += 512) { const int k = idx / 20, j = idx % 20; rw[idx] = j < 4 ? a.in[13][k * 4 + j] : a.in[15][k * 16 + (j - 4)]; }
    __syncthreads();
    for (int m = vcu * 8 + wave; m < MTOK; m += G * 8) {
        const f32x4* xr = (const f32x4*)(H + (size_t)m * DM) + lane; const f32x4* gr = (const f32x4*)a.in[12] + lane;
        f32x4 v[4]; float s = 0.f;
#pragma unroll
        for (int j = 0; j < 4; ++j) { v[j] = xr[64 * j]; s += (v[j].x * v[j].x + v[j].y * v[j].y) + (v[j].z * v[j].z + v[j].w * v[j].w); }
        const float rstd = rsqrtf(wave_sum(s) * (1.f / DM) + EPS);
        float lg[20];
#pragma unroll
        for (int j = 0; j < 20; ++j) lg[j] = 0.f;
        unsigned long long* o8 = (unsigned long long*)(HN + (size_t)m * DM) + lane;
#pragma unroll
        for (int j = 0; j < 4; ++j) { const f32x4 gg = gr[64 * j]; f32x4 hn; hn.x = v[j].x * rstd * gg.x; hn.y = v[j].y * rstd * gg.y; hn.z = v[j].z * rstd * gg.z; hn.w = v[j].w * rstd * gg.w;
            o8[64 * j] = (unsigned long long)cvtpk(hn.x, hn.y) | ((unsigned long long)cvtpk(hn.z, hn.w) << 32);
#pragma unroll
            for (int e = 0; e < 4; ++e) { const int k = 256 * j + 4 * lane + e; const LAS f32x4* wp = (const LAS f32x4*)(rw + k * 20); const float hv = hn[e];
#pragma unroll
                for (int q = 0; q < 5; ++q) { const f32x4 w = wp[q]; lg[4 * q] += hv * w.x; lg[4 * q + 1] += hv * w.y; lg[4 * q + 2] += hv * w.z; lg[4 * q + 3] += hv * w.w; }
                asm volatile("" ::: "memory"); } }
#pragma unroll
        for (int j = 0; j < 20; ++j) lg[j] = wave_sum(lg[j]);
        if (lane == 0) {
            float gl[4]; int gs = 0;
#pragma unroll
            for (int j = 0; j < 4; ++j) gl[j] = lg[j] + a.in[14][j];
#pragma unroll
            for (int j = 1; j < 4; ++j) if (gl[j] > gl[gs]) gs = j;
            float den = 0.f;
#pragma unroll
            for (int j = 0; j < 4; ++j) den += __expf(gl[j] - gl[gs]);
            const float pg = 1.f / den;
            float el[4];
#pragma unroll
            for (int j = 0; j < 4; ++j) { float vsel = 0.f;
#pragma unroll
                for (int gq = 0; gq < 4; ++gq) if (gq == gs) vsel = lg[4 + 4 * gq + j] + a.in[16][4 * gq + j];
                el[j] = vsel; }
            int t1 = 0;
#pragma unroll
            for (int j = 1; j < 4; ++j) if (el[j] > el[t1]) t1 = j;
            int t2 = t1 == 0 ? 1 : 0;
#pragma unroll
            for (int j = 0; j < 4; ++j) if (j != t1 && el[j] > el[t2]) t2 = j;
            float v1 = 0.f, v2 = 0.f;
#pragma unroll
            for (int j = 0; j < 4; ++j) { if (j == t1) v1 = el[j]; if (j == t2) v2 = el[j]; }
            const float w1 = pg / (1.f + __expf(v2 - v1)), w2 = pg - w1;
            const int lo = t1 < t2 ? t1 : t2, hi = t1 < t2 ? t2 : t1;
            const int pr = lo == 0 ? hi - 1 : (lo == 1 ? hi + 1 : 5);
            const int cl = gs * 6 + pr;
            const unsigned pos = __hip_atomic_fetch_add(ctl + CW_CNT + 64 * cl, 1u, __ATOMIC_RELAXED, __HIP_MEMORY_SCOPE_AGENT);
            lists[(size_t)cl * MTOK + pos] = m;
            f32x2 w; w.x = t1 < t2 ? w1 : w2; w.y = t1 < t2 ? w2 : w1; wts[m] = w;
        }
    }
}
DI void phase_norm_rows(const float* H, const float* g, bf16_t* O, int vcu, int G, int lane, int wave) {
    for (int m = vcu * 8 + wave; m < MTOK; m += G * 8) rms_row_to_bf16(H + (size_t)m * DM, g, O + (size_t)m * DM, lane);
}
DI void phase_final_norm(float* H, const float* g, int vcu, int G, int lane, int wave) {
    for (int m = vcu * 8 + wave; m < MTOK; m += G * 8) {
        f32x4* xr = (f32x4*)(H + (size_t)m * DM) + lane; const f32x4* gr = (const f32x4*)g + lane;
        f32x4 v[4]; float s = 0.f;
#pragma unroll
        for (int j = 0; j < 4; ++j) { v[j] = xr[64 * j]; s += (v[j].x * v[j].x + v[j].y * v[j].y) + (v[j].z * v[j].z + v[j].w * v[j].w); }
        const float rstd = rsqrtf(wave_sum(s) * (1.f / DM) + EPS);
#pragma unroll
        for (int j = 0; j < 4; ++j) { const f32x4 gg = gr[64 * j]; f32x4 o; o.x = v[j].x * rstd * gg.x; o.y = v[j].y * rstd * gg.y; o.z = v[j].z * rstd * gg.z; o.w = v[j].w * rstd * gg.w; xr[64 * j] = o; }
    }
}

constexpr int NPHASE = 13;
__global__ void __launch_bounds__(512, 2) hymba_fwd(Args args) {
    extern __shared__ __attribute__((aligned(16))) unsigned char lds_raw[];
    LAS unsigned char* lds = (LAS unsigned char*)lds_raw;
    const int tid = threadIdx.x, lane = tid & 63, wave = __builtin_amdgcn_readfirstlane(tid >> 6);
    const int G = gridDim.x; const int bx = blockIdx.x; const int vcu = (G % 8 == 0) ? (bx % 8) * (G / 8) + bx / 8 : bx;
    volatile LAS unsigned* MISC = (volatile LAS unsigned*)(lds + MISC_OFF);
    for (int u = tid; u < 128; u += 512) MISC[u] = 0u;
    __syncthreads();
    unsigned char* ws = args.ws;
    unsigned* ctl = (unsigned*)(ws + WS_CTL);
    XcdBarrier bar; bar.bar = ctl + CW_BAR; bar.x = 0; bar.st = nullptr;
    if (MK_N_LAUNCHES == 1) bar = xcd_barrier_post(ctl + CW_BAR, MISC + 8);
    const int lo = args.ph_lo, hi = args.ph_hi;
#ifdef ONLY_PHASE
#define IN(k) ((k) == ONLY_PHASE && lo <= (k) && (k) < hi)
#else
#define IN(k) (lo <= (k) && (k) < hi)
#endif
#define SEAM(k) do { if (MK_N_LAUNCHES == 1 && IN(k) && IN((k) + 1)) xcd_barrier(bar); } while (0)
    bf16_t* XN = (bf16_t*)(ws + WS_XN); bf16_t* PROJ = (bf16_t*)(ws + WS_PROJ); bf16_t* MIX = (bf16_t*)(ws + WS_MIX);

    if (IN(0)) { phase_prologue(args, lds, vcu, G, tid, lane, wave); } SEAM(0);
    if (IN(1)) {
        phase_dtf(args, vcu, G, lane, wave);
        pg8::Gemm g{XN, DM, DM, DM, DM / 64}; pg8::DenseSched S; S.init(MTOK, NPROJ, G, bx, (const bf16_t*)(ws + WS_WIN), DM);
        pg8::EpiBf16 E{PROJ, NPROJ, PC_Q / 256, PC_K / 256, QSCALE};
        pg8::gemm_phase<pg8::EpiBf16, pg8::DenseSched, true>(lds, g, S, E);
    } SEAM(1);
    if (IN(2)) { phase_fcb(args, vcu, G, lane, wave); phase_ssd_states(args, lds, vcu, G, tid, lane, wave); } SEAM(2);
    if (IN(3)) { phase_ssd_scan(args, vcu, G, tid); } SEAM(3);
    if (IN(4)) { phase_ssd_out(args, lds, vcu, G, tid, lane, wave); __syncthreads(); phase_attn(args, lds, vcu, G, tid, lane, wave); } SEAM(4);
    if (IN(5)) {
        pg8::Gemm g{MIX, DM, DM, DM, DM / 64}; pg8::DenseSched S; S.init(MTOK, DM, G, bx, (const bf16_t*)(ws + WS_WOUT), DM);
        pg8::EpiRes E{args.in[0], args.out};
        pg8::gemm_phase<pg8::EpiRes, pg8::DenseSched, true>(lds, g, S, E);
    } SEAM(5);
    if (IN(6)) {
        phase_route(args, lds, vcu, G, tid, lane, wave);
        __syncthreads();
        pg8::Gemm g{(const bf16_t*)(ws + WS_PB), 256, 256, 256, 4}; pg8::DenseSched S; S.init(MTOK, DM, G, bx, (const bf16_t*)(ws + WS_WPP), 256);
        pg8::EpiBf16 E{(bf16_t*)(ws + WS_PP), DM, 0, 0, 1.f};
        pg8::gemm_phase<pg8::EpiBf16, pg8::DenseSched, true>(lds, g, S, E);
    } SEAM(6);
    if (IN(7)) {
        pg8::Gemm g{XN, DM, DM, DM, DM / 64}; pg8::MoeSched S{ctl + CW_CNT, (const int*)(ws + WS_LIST), (const bf16_t*)(ws + WS_WGU), 8, G, bx, 1};
        pg8::EpiMoe1 E{(bf16_t*)(ws + WS_HID), (const f32x2*)(ws + WS_WTS)};
        pg8::gemm_phase<pg8::EpiMoe1, pg8::MoeSched, true>(lds, g, S, E);
    } SEAM(7);
    if (IN(8)) {
        pg8::Gemm g{(const bf16_t*)(ws + WS_HID), DM, 512, DM, 8}; pg8::MoeSched S{ctl + CW_CNT, (const int*)(ws + WS_LIST), (const bf16_t*)(ws + WS_WD), 4, G, bx, 2};
        pg8::EpiMoe2 E{args.out};
        pg8::gemm_phase<pg8::EpiMoe2, pg8::MoeSched, true>(lds, g, S, E);
    } SEAM(8);
    if (IN(9)) { phase_norm_rows(args.out, args.in[20], XN, vcu, G, lane, wave); } SEAM(9);
    if (IN(10)) {
        pg8::Gemm g{XN, DM, DM, DM, DM / 64}; pg8::DenseSched S; S.init(MTOK, DM, G, bx, (const bf16_t*)(ws + WS_WPG), DM);
        pg8::EpiPle E{args.out, (const bf16_t*)(ws + WS_PP)};
        pg8::gemm_phase<pg8::EpiPle, pg8::DenseSched, true>(lds, g, S, E);
    } SEAM(10);
    if (IN(11)) { phase_final_norm(args.out, args.in[23], vcu, G, lane, wave); }
#undef IN
#undef SEAM
}

extern "C" void kernel_launch(void* const* d_in, const int* in_sizes, int n_in, void* d_out, int out_size, void* d_ws, size_t ws_size, hipStream_t stream) {
    static int grid = 0;
    if (grid == 0) {
        if (n_in != 24 || out_size != MTOK * DM || ws_size < WS_END) { fprintf(stderr, "kernel_launch: unexpected shapes (n_in %d, out %d, ws %zu)\n", n_in, out_size, ws_size); grid = -1; return; }
        int dev = 0, cus = 0, per_cu = 0;
        if (hipGetDevice(&dev) != hipSuccess || hipDeviceGetAttribute(&cus, hipDeviceAttributeMultiprocessorCount, dev) != hipSuccess) { grid = -1; return; }
        if (hipFuncSetAttribute((const void*)hymba_fwd, hipFuncAttributeMaxDynamicSharedMemorySize, LDS_BYTES) != hipSuccess) { fprintf(stderr, "kernel_launch: hipFuncSetAttribute failed\n"); grid = -1; return; }
        if (hipOccupancyMaxActiveBlocksPerMultiprocessor(&per_cu, (const void*)hymba_fwd, 512, LDS_BYTES) != hipSuccess || per_cu < 1) { fprintf(stderr, "kernel_launch: occupancy query reports %d\n", per_cu); }
        (void)hipGetLastError();
        grid = cus;
    }
    if (grid < 0) return;
    if (hipMemsetAsync((char*)d_ws + WS_CTL, 0, CTL_ZERO_BYTES, stream) != hipSuccess) return;
    Args a{};
    for (int i = 0; i < 24; ++i) a.in[i] = (const float*)d_in[i];
    a.out = (float*)d_out; a.ws = (unsigned char*)d_ws;
    if (MK_N_LAUNCHES == 1) { a.ph_lo = 0; a.ph_hi = NPHASE; hipLaunchKernelGGL(hymba_fwd, dim3(grid), dim3(512), LDS_BYTES, stream, a); }
    else for (int p = 0; p < 12; ++p) { a.ph_lo = p; a.ph_hi = p + 1; hipLaunchKernelGGL(hymba_fwd, dim3(grid), dim3(512), LDS_BYTES, stream, a); }
}
```
